# Optimizing an MI355X kernel written in HIP

```python
import jax, jax.numpy as jnp
from jax import lax
import numpy as np

D_MODEL = 1024
BATCH = 2
SEQ = 8192
DEPTH = 1

N_HEADS_A = 8
N_KV_A = 2
HEAD_DIM_A = 64
WINDOW = 128
BLOCK = 128
N_HEADS_B = 8
QK_NOPE = 64
QK_ROPE = 32
V_DIM_B = 64
Q_LORA = 256
KV_LORA = 128
ROPE_THETA = 10000.0
D_FF = 4 * D_MODEL
EPS = 1e-6

WIDTH_A = N_HEADS_A * HEAD_DIM_A
WIDTH_B = N_HEADS_B * V_DIM_B
KV_WIDTH_A = N_KV_A * HEAD_DIM_A
Q_HEAD_B = QK_NOPE + QK_ROPE
KV_HEAD_B = QK_NOPE + V_DIM_B
SPLITS = (D_MODEL, D_MODEL, WIDTH_A, KV_WIDTH_A, KV_WIDTH_A, Q_LORA, KV_LORA, QK_ROPE)
D_IN = int(sum(SPLITS))
SPLIT_IDX = tuple(int(i) for i in np.cumsum(SPLITS)[:-1])

kernel_name = "hybrid_swa_sink_alibi_mla_gated_sqrelu"


def rmsnorm(x, g):
    x32 = x.astype(jnp.float32)
    y = x32 * lax.rsqrt(jnp.mean(x32 * x32, axis=-1, keepdims=True) + EPS)
    return y.astype(x.dtype) * g


def alibi_slopes(n):
    return 2.0 ** (-8.0 * jnp.arange(1, n + 1, dtype=jnp.float32) / n)


def rope(x, pos):
    d = x.shape[-1]
    freqs = ROPE_THETA ** (-jnp.arange(0, d, 2, dtype=jnp.float32) / d)
    ang = pos.astype(jnp.float32)[..., None] * freqs
    cos, sin = jnp.cos(ang)[:, :, None, :], jnp.sin(ang)[:, :, None, :]
    x32 = x.astype(jnp.float32)
    x1, x2 = x32[..., : d // 2], x32[..., d // 2:]
    return jnp.concatenate([x1 * cos - x2 * sin, x2 * cos + x1 * sin], axis=-1).astype(x.dtype)


def swa_sink_alibi_attention(q, k, v, pos, sinks):
    B, S = q.shape[0], q.shape[1]
    nb = S // BLOCK
    G = N_HEADS_A // N_KV_A
    qb = q.reshape(B, nb, BLOCK, N_KV_A, G, HEAD_DIM_A)

    def band(t):
        padded = jnp.pad(t, [(0, 0), (BLOCK, 0)] + [(0, 0)] * (t.ndim - 2))
        prev = padded[:, :S].reshape((B, nb, BLOCK) + t.shape[2:])
        cur = t.reshape((B, nb, BLOCK) + t.shape[2:])
        return jnp.concatenate([prev, cur], axis=2)

    kb, vb, pb = band(k), band(v), band(pos)
    qpos = pos.reshape(B, nb, BLOCK)
    scale = HEAD_DIM_A ** -0.5
    s = jnp.einsum('bnqkgd,bnskd->bnkgqs', qb, kb).astype(jnp.float32) * scale
    dist = jnp.abs(qpos[:, :, :, None] - pb[:, :, None, :]).astype(jnp.float32)
    slopes = alibi_slopes(N_HEADS_A).reshape(N_KV_A, G)
    s = s - slopes[None, None, :, :, None, None] * dist[:, :, None, None]
    qi = jnp.arange(BLOCK)[:, None] + BLOCK
    si = jnp.arange(2 * BLOCK)[None, :]
    diff = qi - si
    valid = (diff >= 0) & (diff < WINDOW)
    not_pad = (jnp.arange(nb)[:, None, None] > 0) | (si[None] >= BLOCK)
    mask = valid[None] & not_pad
    s = jnp.where(mask[None, :, None, None], s, -jnp.inf)
    sink = sinks.astype(jnp.float32).reshape(1, 1, N_KV_A, G, 1, 1)
    m = jnp.maximum(jnp.max(s, axis=-1, keepdims=True), sink)
    e = jnp.exp(s - m)
    p = e / (jnp.sum(e, axis=-1, keepdims=True) + jnp.exp(sink - m))
    o = jnp.einsum('bnkgqs,bnskd->bnqkgd', p.astype(v.dtype), vb)
    return o.reshape(B, S, WIDTH_A)


def mla_attention(q_nope, q_rope, k_nope, k_rope, v):
    B, S = q_nope.shape[0], q_nope.shape[1]
    nb = S // BLOCK
    scale = Q_HEAD_B ** -0.5
    qn = q_nope.reshape(B, nb, BLOCK, N_HEADS_B, QK_NOPE).transpose(1, 0, 2, 3, 4)
    qr = q_rope.reshape(B, nb, BLOCK, N_HEADS_B, QK_ROPE).transpose(1, 0, 2, 3, 4)
    kidx = jnp.arange(S)

    def one_block(args):
        qn_b, qr_b, i = args
        s = (jnp.einsum('bqhd,bshd->bhqs', qn_b, k_nope)
             + jnp.einsum('bqhd,bsd->bhqs', qr_b, k_rope)).astype(jnp.float32) * scale
        qidx = i * BLOCK + jnp.arange(BLOCK)
        s = jnp.where(kidx[None, :] <= qidx[:, None], s, -jnp.inf)
        p = jax.nn.softmax(s, axis=-1)
        return jnp.einsum('bhqs,bshd->bqhd', p.astype(v.dtype), v)

    o = lax.map(one_block, (qn, qr, jnp.arange(nb)))
    return o.transpose(1, 0, 2, 3, 4).reshape(B, S, WIDTH_B)


def setup_inputs(seed: int = 0) -> dict:
    key = jax.random.key(seed)
    ks = jax.random.split(key, 20)

    def w(k, shape, fan_in):
        return jax.random.normal(k, shape, jnp.float32) * fan_in ** -0.5

    def gain(k, n):
        return 1.0 + 0.02 * jax.random.normal(k, (DEPTH, n), jnp.float32)

    x = jax.random.normal(ks[0], (BATCH, SEQ, D_MODEL), jnp.float32)
    offset = jax.random.randint(ks[1], (BATCH, 1), 0, 1024, dtype=jnp.int32)
    positions = (offset + jnp.arange(SEQ, dtype=jnp.int32)[None, :]).astype(jnp.int32)
    return {
        "x": x,
        "positions": positions,
        "pre_norm_mix": gain(ks[2], D_MODEL),
        "w_in": w(ks[3], (DEPTH, D_MODEL, D_IN), D_MODEL),
        "q_a_norm": gain(ks[4], Q_LORA),
        "w_q_b": w(ks[5], (DEPTH, Q_LORA, N_HEADS_B * Q_HEAD_B), Q_LORA),
        "kv_a_norm": gain(ks[6], KV_LORA),
        "w_kv_b": w(ks[7], (DEPTH, KV_LORA, N_HEADS_B * KV_HEAD_B), KV_LORA),
        "sinks": jax.random.normal(ks[8], (DEPTH, N_HEADS_A), jnp.float32),
        "w_o_a": w(ks[9], (DEPTH, WIDTH_A, D_MODEL), WIDTH_A),
        "w_o_b": w(ks[10], (DEPTH, WIDTH_B, D_MODEL), WIDTH_B),
        "w_out": w(ks[11], (DEPTH, D_MODEL, D_MODEL), D_MODEL),
        "post_norm_mix": gain(ks[12], D_MODEL),
        "pre_norm_mlp": gain(ks[13], D_MODEL),
        "w_up": w(ks[14], (DEPTH, D_MODEL, D_FF), D_MODEL),
        "w_down": w(ks[15], (DEPTH, D_FF, D_MODEL), D_FF),
        "post_norm_mlp": gain(ks[16], D_MODEL),
    }


def reference(x, positions, pre_norm_mix, w_in, q_a_norm, w_q_b, kv_a_norm, w_kv_b, sinks,
              w_o_a, w_o_b, w_out, post_norm_mix, pre_norm_mlp, w_up, w_down, post_norm_mlp):
    B, S = x.shape[0], x.shape[1]
    for l in range(DEPTH):
        h = rmsnorm(x, pre_norm_mix[l])
        proj = h @ w_in[l]
        g_a, g_b, qa, ka, va, cq, ckv, kr = jnp.split(proj, SPLIT_IDX, axis=-1)
        qa = qa.reshape(B, S, N_HEADS_A, HEAD_DIM_A)
        ka = ka.reshape(B, S, N_KV_A, HEAD_DIM_A)
        va = va.reshape(B, S, N_KV_A, HEAD_DIM_A)
        out_a = swa_sink_alibi_attention(qa, ka, va, positions, sinks[l])
        qb = (rmsnorm(cq, q_a_norm[l]) @ w_q_b[l]).reshape(B, S, N_HEADS_B, Q_HEAD_B)
        kvb = (rmsnorm(ckv, kv_a_norm[l]) @ w_kv_b[l]).reshape(B, S, N_HEADS_B, KV_HEAD_B)
        q_nope, q_rope = qb[..., :QK_NOPE], rope(qb[..., QK_NOPE:], positions)
        k_nope, v_b = kvb[..., :QK_NOPE], kvb[..., QK_NOPE:]
        k_rope = rope(kr[:, :, None, :], positions)[:, :, 0, :]
        out_b = mla_attention(q_nope, q_rope, k_nope, k_rope, v_b)
        merged = jax.nn.sigmoid(g_a) * (out_a @ w_o_a[l]) + jax.nn.sigmoid(g_b) * (out_b @ w_o_b[l])
        x = x + rmsnorm(merged @ w_out[l], post_norm_mix[l])
        h2 = rmsnorm(x, pre_norm_mlp[l])
        y = jnp.square(jax.nn.relu(h2 @ w_up[l])) @ w_down[l]
        x = x + rmsnorm(y, post_norm_mlp[l])
    return x
```

```cpp
#include <hip/hip_runtime.h>
#include <cstdio>
#include <cstdint>
#include <cmath>

constexpr int BATCH = 2, SEQ = 8192, DM = 1024, M = BATCH * SEQ;
constexpr int NIN = 3232, NINP = 3328;
constexpr int NQB = 768, NKVB = 1024, FF = 4096;
constexpr float EPS = 1e-6f;
constexpr float LOG2E = 1.4426950408889634f;
constexpr float CA = 0.125f * LOG2E;
constexpr float C2M = 0.10206207261596577f * LOG2E;

typedef unsigned short bf16;
typedef float f32x4 __attribute__((ext_vector_type(4)));
typedef float f32x2 __attribute__((ext_vector_type(2)));
typedef unsigned u32x4 __attribute__((ext_vector_type(4)));
typedef unsigned u32x2 __attribute__((ext_vector_type(2)));
typedef __bf16 bf16x2_t __attribute__((ext_vector_type(2)));

constexpr size_t MiB = 1u << 20;
constexpr size_t WS_CTL = 0, CTL_ZERO_BYTES = 1 * MiB;
constexpr size_t WS_WIN = 2 * MiB;
constexpr size_t WS_WQB = WS_WIN + (size_t)NINP * DM * 2;
constexpr size_t WS_WKVB = WS_WQB + (size_t)NQB * 256 * 2;
constexpr size_t WS_WOA = WS_WKVB + (size_t)NKVB * 128 * 2;
constexpr size_t WS_WOB = WS_WOA + (size_t)DM * 512 * 2;
constexpr size_t WS_WOUT = WS_WOB + (size_t)DM * 512 * 2;
constexpr size_t WS_WUP = WS_WOUT + (size_t)DM * DM * 2;
constexpr size_t WS_WDN = WS_WUP + (size_t)FF * DM * 2;
constexpr size_t WS_WEND = WS_WDN + (size_t)DM * FF * 2;
static_assert(WS_WEND <= 30 * MiB, "weights");
constexpr size_t WS_X = 30 * MiB;
constexpr size_t WS_XN = 32 * MiB;
constexpr size_t WS_OA = WS_XN, WS_OB = WS_XN + 16 * MiB;
constexpr size_t WS_G = 64 * MiB;
constexpr size_t WS_QA = 128 * MiB, WS_KA = 144 * MiB, WS_VA = 148 * MiB, WS_CQ = 152 * MiB, WS_CKV = 160 * MiB, WS_KR = 164 * MiB;
constexpr size_t WS_SSQ_CQ = 165 * MiB, WS_SSQ_CKV = WS_SSQ_CQ + 512 * 1024;
constexpr size_t WS_QB = 166 * MiB, WS_KN = 190 * MiB, WS_VB = 206 * MiB;
constexpr size_t WS_MRG = 222 * MiB;
constexpr size_t WS_H = 64 * MiB;
constexpr size_t WS_Y1 = 64 * MiB;
constexpr size_t WS_Y2 = 192 * MiB;
constexpr size_t WS_END = 256 * MiB;

__device__ __forceinline__ unsigned cvtpk(float lo, float hi) { f32x2 v = {lo, hi}; bf16x2_t b = __builtin_convertvector(v, bf16x2_t); return __builtin_bit_cast(unsigned, b); }
__device__ __forceinline__ float bf2f(bf16 u) { return __uint_as_float((unsigned)u << 16); }
__device__ __forceinline__ u32x4 pack8(f32x4 a, f32x4 b) { u32x4 w; w.x = cvtpk(a[0], a[1]); w.y = cvtpk(a[2], a[3]); w.z = cvtpk(b[0], b[1]); w.w = cvtpk(b[2], b[3]); return w; }
__device__ __forceinline__ void unpack8(u32x4 w, f32x4& a, f32x4& b) {
    a[0] = __uint_as_float(w.x << 16); a[1] = __uint_as_float(w.x & 0xffff0000u); a[2] = __uint_as_float(w.y << 16); a[3] = __uint_as_float(w.y & 0xffff0000u);
    b[0] = __uint_as_float(w.z << 16); b[1] = __uint_as_float(w.z & 0xffff0000u); b[2] = __uint_as_float(w.w << 16); b[3] = __uint_as_float(w.w & 0xffff0000u); }
__device__ __forceinline__ float sigmoidf_(float v) { return __builtin_amdgcn_rcpf(1.0f + __builtin_amdgcn_exp2f(-v * LOG2E)); }
__device__ __forceinline__ void sincos_acc(float a, float& s, float& c) {
    const float k = rintf(a * 0.15915494309189535f);
    float r = fmaf(-k, 6.28125f, a); r = fmaf(-k, 1.9350051879882812e-3f, r); r = fmaf(-k, 3.0199159819567e-07f, r);
    const float rev = r * 0.15915494309189535f;
    s = __builtin_amdgcn_sinf(rev); c = __builtin_amdgcn_cosf(rev);
}
__device__ __forceinline__ void rope8(int pos, int fq, f32x4& v0, f32x4& v1) {
    const float p = (float)pos;
#pragma unroll
    for (int j = 0; j < 4; ++j) {
        const float fr = exp2f(-(float)(4 * fq + j) * 0.8304820237218406f);
        float s, c; sincos_acc(p * fr, s, c);
        const float x1 = v0[j], x2 = v1[j]; v0[j] = x1 * c - x2 * s; v1[j] = x2 * c + x1 * s;
    }
}
__host__ __device__ __forceinline__ int rperm(int p) { const int fq = p >> 3, j = p & 7; return j < 4 ? 4 * fq + j : 16 + 4 * fq + (j - 4); }

struct EpiIn {
    bf16 *G, *QA, *KA, *VA, *CQ, *CKV, *KR; const int* pos;
    __device__ __forceinline__ void elem8(int row, int col, f32x4 v0, f32x4 v1) const {
        if (col < 2048) {
#pragma unroll
            for (int j = 0; j < 4; ++j) { v0[j] = sigmoidf_(v0[j]); v1[j] = sigmoidf_(v1[j]); }
            *(u32x4*)(G + (size_t)row * 2048 + col) = pack8(v0, v1);
        } else if (col < 2560) { *(u32x4*)(QA + (size_t)row * 512 + (col - 2048)) = pack8(v0 * CA, v1 * CA); }
        else if (col < 2688) { *(u32x4*)(KA + (size_t)row * 128 + (col - 2560)) = pack8(v0, v1); }
        else if (col < 2816) { *(u32x4*)(VA + (size_t)row * 128 + (col - 2688)) = pack8(v0, v1); }
        else if (col < 3072) { *(u32x4*)(CQ + (size_t)row * 256 + (col - 2816)) = pack8(v0, v1); }
        else if (col < 3200) { *(u32x4*)(CKV + (size_t)row * 128 + (col - 3072)) = pack8(v0, v1); }
        else if (col < 3232) { rope8(pos[row], (col - 3200) >> 3, v0, v1); *(u32x4*)(KR + (size_t)row * 32 + (col - 3200)) = pack8(v0, v1); }
    }
};
struct EpiQB {
    bf16* QB; const float* ssq; const int* pos;
    __device__ __forceinline__ float rowscale(int row) const { const f32x4 s = *(const f32x4*)(ssq + (size_t)row * 4); return rsqrtf(((s[0] + s[1]) + (s[2] + s[3])) * (1.0f / 256.0f) + EPS) * C2M; }
    __device__ __forceinline__ void elem8s(int row, int col, f32x4 v0, f32x4 v1, float rs) const {
        v0 = v0 * rs; v1 = v1 * rs; const int h = col / 96, r = col - 96 * h;
        if (r >= 64) rope8(pos[row], (r - 64) >> 3, v0, v1);
        *(u32x4*)(QB + (size_t)row * NQB + col) = pack8(v0, v1);
    }
    __device__ __forceinline__ void elem8(int row, int col, f32x4 v0, f32x4 v1) const { elem8s(row, col, v0, v1, rowscale(row)); }
};
struct EpiKVB {
    bf16 *KN, *VB; const float* ssq;
    __device__ __forceinline__ float rowscale(int row) const { const f32x4 s = *(const f32x4*)(ssq + (size_t)row * 4); return rsqrtf(((s[0] + s[1]) + (s[2] + s[3])) * (1.0f / 128.0f) + EPS); }
    __device__ __forceinline__ void elem8s(int row, int col, f32x4 v0, f32x4 v1, float rs) const {
        bf16* dst = col < 512 ? KN + (size_t)row * 512 + col : VB + (size_t)row * 512 + (col - 512);
        *(u32x4*)dst = pack8(v0 * rs, v1 * rs);
    }
    __device__ __forceinline__ void elem8(int row, int col, f32x4 v0, f32x4 v1) const { elem8s(row, col, v0, v1, rowscale(row)); }
};
struct EpiGate {
    const bf16* G; bf16* MRG;
    __device__ __forceinline__ void mid(int row, int col, f32x4& v0, f32x4& v1) const {
        f32x4 a0, a1, b0, b1; unpack8(*(const u32x4*)(G + (size_t)row * 2048 + col), a0, a1); unpack8(*(const u32x4*)(G + (size_t)row * 2048 + 1024 + col), b0, b1);
#pragma unroll
        for (int j = 0; j < 4; ++j) { v0[j] *= a0[j] * __builtin_amdgcn_rcpf(b0[j]); v1[j] *= a1[j] * __builtin_amdgcn_rcpf(b1[j]); }
    }
    __device__ __forceinline__ void elem8(int row, int col, f32x4 v0, f32x4 v1) const {
        f32x4 b0, b1; unpack8(*(const u32x4*)(G + (size_t)row * 2048 + 1024 + col), b0, b1);
        *(u32x4*)(MRG + (size_t)row * DM + col) = pack8(v0 * b0, v1 * b1);
    }
};
struct EpiRelu2 { bf16* H;
    __device__ __forceinline__ void elem8(int row, int col, f32x4 v0, f32x4 v1) const {
#pragma unroll
        for (int j = 0; j < 4; ++j) { const float a = fmaxf(v0[j], 0.f), b = fmaxf(v1[j], 0.f); v0[j] = a * a; v1[j] = b * b; }
        *(u32x4*)(H + (size_t)row * FF + col) = pack8(v0, v1);
    }
};
struct EpiY { float* Y;
    __device__ __forceinline__ void elem8(int row, int col, f32x4 v0, f32x4 v1) const { *(f32x4*)(Y + (size_t)row * DM + col) = v0; *(f32x4*)(Y + (size_t)row * DM + col + 4) = v1; }
};

#define LAS __attribute__((address_space(3)))
__device__ __forceinline__ float wave_sum(float v) {
#pragma unroll
    for (int o = 1; o < 64; o <<= 1) v += __shfl_xor(v, o);
    return v;
}
__device__ __forceinline__ int src_in(int n) { return n < 3200 ? n : (n < 3232 ? 3200 + rperm(n - 3200) : -1); }
__device__ __forceinline__ int src_qb(int n) { const int h = n / 96, r = n - 96 * h; return r < 64 ? n : 96 * h + 64 + rperm(r - 64); }
__device__ __forceinline__ int src_kvb(int n) { return n < 512 ? (n >> 6) * 128 + (n & 63) : ((n - 512) >> 6) * 128 + 64 + (n & 63); }
template <int MODE>
__device__ __forceinline__ void transpose_item(const float* W, int K, int Nsrc, bf16* WT, const float* gk, LAS float* scr, int item, int nblk, int lane) {
    const int kb = item / nblk, nb = item % nblk, k0 = 64 * kb, n0 = 32 * nb;
    const int nd = n0 + (lane & 31);
    const int sc = MODE == 0 ? nd : (MODE == 1 ? src_in(nd) : (MODE == 2 ? src_qb(nd) : src_kvb(nd)));
#pragma unroll 8
    for (int i = 0; i < 32; ++i) { const int kk = 2 * i + (lane >> 5); float v = sc >= 0 ? W[(size_t)(k0 + kk) * Nsrc + sc] : 0.f; if (gk) v *= gk[k0 + kk]; scr[kk * 33 + (lane & 31)] = v; }
    asm volatile("s_waitcnt lgkmcnt(0)" ::: "memory");
    const int c = lane & 7;
#pragma unroll
    for (int j = 0; j < 4; ++j) { const int n = (lane >> 3) + 8 * j; const LAS float* s = scr + (8 * c) * 33 + n;
        u32x4 o; o.x = cvtpk(s[0 * 33], s[1 * 33]); o.y = cvtpk(s[2 * 33], s[3 * 33]); o.z = cvtpk(s[4 * 33], s[5 * 33]); o.w = cvtpk(s[6 * 33], s[7 * 33]);
        *(u32x4*)(WT + (size_t)(n0 + n) * K + k0 + 8 * c) = o; }
    asm volatile("s_waitcnt lgkmcnt(0)" ::: "memory");
}
struct Ptrs {
    const float* x; const int* pos; const float *g_pre, *w_in, *g_q, *w_qb, *g_kv, *w_kvb, *sinks, *w_oa, *w_ob, *w_out, *g_post, *g_mlp, *w_up, *w_dn, *g_postmlp;
    float* out; unsigned char* ws;
};
__device__ __forceinline__ void prologue(const Ptrs& P, LAS float* scr, int gw, int NGW, int lane) {
    unsigned char* ws = P.ws;
    constexpr int I_IN = (DM / 64) * (NINP / 32), I_QB = (256 / 64) * (NQB / 32), I_KVB = (128 / 64) * (NKVB / 32), I_OA = (512 / 64) * (DM / 32), I_OUT = (DM / 64) * (DM / 32),
                  I_UP = (DM / 64) * (FF / 32), I_DN = (FF / 64) * (DM / 32);
    constexpr int NITEMS = I_IN + I_QB + I_KVB + 2 * I_OA + I_OUT + I_UP + I_DN;
    for (int it = gw; it < NITEMS; it += NGW) {
        int r = it;
        if (r < I_IN) { transpose_item<1>(P.w_in, DM, NIN, (bf16*)(ws + WS_WIN), nullptr, scr, r, NINP / 32, lane); continue; } r -= I_IN;
        if (r < I_QB) { transpose_item<2>(P.w_qb, 256, NQB, (bf16*)(ws + WS_WQB), P.g_q, scr, r, NQB / 32, lane); continue; } r -= I_QB;
        if (r < I_KVB) { transpose_item<3>(P.w_kvb, 128, NKVB, (bf16*)(ws + WS_WKVB), P.g_kv, scr, r, NKVB / 32, lane); continue; } r -= I_KVB;
        if (r < I_OA) { transpose_item<0>(P.w_oa, 512, DM, (bf16*)(ws + WS_WOA), nullptr, scr, r, DM / 32, lane); continue; } r -= I_OA;
        if (r < I_OA) { transpose_item<0>(P.w_ob, 512, DM, (bf16*)(ws + WS_WOB), nullptr, scr, r, DM / 32, lane); continue; } r -= I_OA;
        if (r < I_OUT) { transpose_item<0>(P.w_out, DM, DM, (bf16*)(ws + WS_WOUT), nullptr, scr, r, DM / 32, lane); continue; } r -= I_OUT;
        if (r < I_UP) { transpose_item<0>(P.w_up, DM, FF, (bf16*)(ws + WS_WUP), nullptr, scr, r, FF / 32, lane); continue; } r -= I_UP;
        transpose_item<0>(P.w_dn, FF, DM, (bf16*)(ws + WS_WDN), nullptr, scr, r, DM / 32, lane);
    }
    bf16* XN = (bf16*)(ws + WS_XN);
    for (int m = gw; m < M; m += NGW) {
        const f32x4* xr = (const f32x4*)(P.x + (size_t)m * DM) + lane; const f32x4* gr = (const f32x4*)P.g_pre + lane;
        f32x4 v[4]; float s = 0.f;
#pragma unroll
        for (int j = 0; j < 4; ++j) { v[j] = xr[64 * j]; s += (v[j][0] * v[j][0] + v[j][1] * v[j][1]) + (v[j][2] * v[j][2] + v[j][3] * v[j][3]); }
        const float rs = rsqrtf(wave_sum(s) * (1.f / DM) + EPS);
        u32x2* o8 = (u32x2*)(XN + (size_t)m * DM) + lane;
#pragma unroll
        for (int j = 0; j < 4; ++j) { const f32x4 g = gr[64 * j]; u32x2 w; w.x = cvtpk(v[j][0] * rs * g[0], v[j][1] * rs * g[1]); w.y = cvtpk(v[j][2] * rs * g[2], v[j][3] * rs * g[3]); o8[64 * j] = w; }
    }
}
__global__ void __launch_bounds__(512) k_prologue(Ptrs P) {
    extern __shared__ __attribute__((aligned(16))) float scr_all[];
    const int tid = threadIdx.x, lane = tid & 63, wave = tid >> 6;
    prologue(P, (LAS float*)scr_all + wave * 64 * 33, blockIdx.x * 8 + wave, gridDim.x * 8, lane);
}

template <class Epi, bool DUAL>
__global__ void __launch_bounds__(256) n_gemm(const bf16* A, const bf16* Bt, const bf16* A2, const bf16* Bt2, int K, Epi E) {
    __shared__ float As[16][132]; __shared__ float Bs[16][68];
    const int tid = threadIdx.x, ty = tid >> 3, tx = tid & 7, row0 = blockIdx.y * 128, col0 = blockIdx.x * 64;
    float acc[4][8];
#pragma unroll
    for (int i = 0; i < 4; ++i)
#pragma unroll
        for (int j = 0; j < 8; ++j) acc[i][j] = 0.f;
    for (int pass = 0; pass < (DUAL ? 2 : 1); ++pass) {
        const bf16* Ap = pass ? A2 : A; const bf16* Bp = pass ? Bt2 : Bt;
        for (int k0 = 0; k0 < K; k0 += 16) {
            { const int r = tid >> 1, ko = (tid & 1) * 8; const u32x4 w = *(const u32x4*)(Ap + (size_t)(row0 + r) * K + k0 + ko); f32x4 a, b; unpack8(w, a, b);
#pragma unroll
              for (int j = 0; j < 4; ++j) { As[ko + j][r] = a[j]; As[ko + 4 + j][r] = b[j]; } }
            if (tid < 128) { const int r = tid >> 1, ko = (tid & 1) * 8; const u32x4 w = *(const u32x4*)(Bp + (size_t)(col0 + r) * K + k0 + ko); f32x4 a, b; unpack8(w, a, b);
#pragma unroll
              for (int j = 0; j < 4; ++j) { Bs[ko + j][r] = a[j]; Bs[ko + 4 + j][r] = b[j]; } }
            __syncthreads();
#pragma unroll
            for (int k = 0; k < 16; ++k) {
                const f32x4 a = *(const f32x4*)&As[k][ty * 4]; const f32x4 b0 = *(const f32x4*)&Bs[k][tx * 8], b1 = *(const f32x4*)&Bs[k][tx * 8 + 4];
#pragma unroll
                for (int i = 0; i < 4; ++i) {
#pragma unroll
                    for (int j = 0; j < 4; ++j) { acc[i][j] = fmaf(a[i], b0[j], acc[i][j]); acc[i][4 + j] = fmaf(a[i], b1[j], acc[i][4 + j]); } }
            }
            __syncthreads();
        }
        if constexpr (DUAL) { if (pass == 0) {
#pragma unroll
            for (int i = 0; i < 4; ++i) { f32x4 v0 = {acc[i][0], acc[i][1], acc[i][2], acc[i][3]}, v1 = {acc[i][4], acc[i][5], acc[i][6], acc[i][7]};
                E.mid(row0 + ty * 4 + i, col0 + tx * 8, v0, v1);
#pragma unroll
                for (int j = 0; j < 4; ++j) { acc[i][j] = v0[j]; acc[i][4 + j] = v1[j]; } } } }
    }
#pragma unroll
    for (int i = 0; i < 4; ++i) { const f32x4 v0 = {acc[i][0], acc[i][1], acc[i][2], acc[i][3]}, v1 = {acc[i][4], acc[i][5], acc[i][6], acc[i][7]};
        E.elem8(row0 + ty * 4 + i, col0 + tx * 8, v0, v1); }
}
__global__ void n_ssq(const bf16* CQ, const bf16* CKV, float* SQ, float* SKV) {
    const int row = blockIdx.x * blockDim.x + threadIdx.x; if (row >= M) return;
    float s = 0.f; for (int i = 0; i < 256; ++i) { const float v = bf2f(CQ[(size_t)row * 256 + i]); s += v * v; }
    float t = 0.f; for (int i = 0; i < 128; ++i) { const float v = bf2f(CKV[(size_t)row * 128 + i]); t += v * v; }
    *(f32x4*)(SQ + (size_t)row * 4) = (f32x4){s, 0.f, 0.f, 0.f}; *(f32x4*)(SKV + (size_t)row * 4) = (f32x4){t, 0.f, 0.f, 0.f};
}
__global__ void __launch_bounds__(256) n_attn_mla(const bf16* QB, const bf16* KN, const bf16* KR, const bf16* VB, bf16* OB) {
    const int idx = blockIdx.x * 256 + threadIdx.x, q = idx % SEQ, bh = idx / SEQ, b = bh >> 3, h = bh & 7;
    const size_t rb = (size_t)b * SEQ;
    float qv[96], o[64];
#pragma unroll
    for (int d = 0; d < 96; ++d) qv[d] = bf2f(QB[(rb + q) * NQB + 96 * h + d]);
#pragma unroll
    for (int d = 0; d < 64; ++d) o[d] = 0.f;
    float m = -1e30f, l = 0.f;
    for (int k = 0; k <= q; ++k) {
        const bf16* kn = KN + (rb + k) * 512 + 64 * h; const bf16* kr = KR + (rb + k) * 32; const bf16* vv = VB + (rb + k) * 512 + 64 * h;
        float s = 0.f;
#pragma unroll
        for (int d = 0; d < 64; ++d) s = fmaf(qv[d], bf2f(kn[d]), s);
#pragma unroll
        for (int d = 0; d < 32; ++d) s = fmaf(qv[64 + d], bf2f(kr[d]), s);
        const float mn = fmaxf(m, s), a = exp2f(m - mn), p = exp2f(s - mn); l = l * a + p; m = mn;
#pragma unroll
        for (int d = 0; d < 64; ++d) o[d] = fmaf(p, bf2f(vv[d]), o[d] * a);
    }
    const float il = 1.f / l;
#pragma unroll
    for (int d = 0; d < 64; d += 2) *(unsigned*)(OB + (rb + q) * 512 + 64 * h + d) = cvtpk(o[d] * il, o[d + 1] * il);
}
__global__ void __launch_bounds__(256) n_attn_swa(const bf16* QA, const bf16* KA, const bf16* VA, const int* pos, const float* sinks, bf16* OA) {
    const int idx = blockIdx.x * 256 + threadIdx.x, q = idx % SEQ, bh = idx / SEQ, b = bh >> 3, hq = bh & 7, kvh = hq >> 2;
    const size_t rb = (size_t)b * SEQ;
    float qv[64], o[64];
#pragma unroll
    for (int d = 0; d < 64; ++d) { qv[d] = bf2f(QA[(rb + q) * 512 + 64 * hq + d]); o[d] = 0.f; }
    const float slope2 = exp2f(-(float)(hq + 1)) * LOG2E; const int qp = pos[rb + q];
    float m = sinks[hq] * LOG2E, l = 1.f;
    const int k0 = q - 127 < 0 ? 0 : q - 127;
    for (int k = k0; k <= q; ++k) {
        const bf16* kk = KA + (rb + k) * 128 + 64 * kvh; const bf16* vv = VA + (rb + k) * 128 + 64 * kvh;
        float s = 0.f;
#pragma unroll
        for (int d = 0; d < 64; ++d) s = fmaf(qv[d], bf2f(kk[d]), s);
        int dd = qp - pos[rb + k]; dd = dd < 0 ? -dd : dd; s -= slope2 * (float)dd;
        const float mn = fmaxf(m, s), a = exp2f(m - mn), p = exp2f(s - mn); l = l * a + p; m = mn;
#pragma unroll
        for (int d = 0; d < 64; ++d) o[d] = fmaf(p, bf2f(vv[d]), o[d] * a);
    }
    const float il = 1.f / l;
#pragma unroll
    for (int d = 0; d < 64; d += 2) *(unsigned*)(OA + (rb + q) * 512 + 64 * hq + d) = cvtpk(o[d] * il, o[d + 1] * il);
}
__global__ void __launch_bounds__(256) n_norm1(const float* Y, const float* x, const float* g_post, const float* g_mlp, float* out, bf16* XN2) {
    const int lane = threadIdx.x & 63, row = blockIdx.x * 4 + (threadIdx.x >> 6);
    const f32x4* yr = (const f32x4*)(Y + (size_t)row * DM) + lane; const f32x4* xr = (const f32x4*)(x + (size_t)row * DM) + lane;
    f32x4 v[4]; float s = 0.f;
#pragma unroll
    for (int j = 0; j < 4; ++j) { v[j] = yr[64 * j]; s += (v[j][0] * v[j][0] + v[j][1] * v[j][1]) + (v[j][2] * v[j][2] + v[j][3] * v[j][3]); }
    const float rs = rsqrtf(wave_sum(s) * (1.f / DM) + EPS); float s2 = 0.f;
#pragma unroll
    for (int j = 0; j < 4; ++j) { v[j] = xr[64 * j] + v[j] * rs * ((const f32x4*)g_post)[lane + 64 * j]; s2 += (v[j][0] * v[j][0] + v[j][1] * v[j][1]) + (v[j][2] * v[j][2] + v[j][3] * v[j][3]); }
    const float rs2 = rsqrtf(wave_sum(s2) * (1.f / DM) + EPS);
#pragma unroll
    for (int j = 0; j < 4; ++j) { ((f32x4*)(out + (size_t)row * DM))[lane + 64 * j] = v[j]; const f32x4 g = ((const f32x4*)g_mlp)[lane + 64 * j];
        u32x2 w; w.x = cvtpk(v[j][0] * rs2 * g[0], v[j][1] * rs2 * g[1]); w.y = cvtpk(v[j][2] * rs2 * g[2], v[j][3] * rs2 * g[3]); ((u32x2*)(XN2 + (size_t)row * DM))[lane + 64 * j] = w; }
}
__global__ void __launch_bounds__(256) n_norm2(const float* Y, const float* g, float* out) {
    const int lane = threadIdx.x & 63, row = blockIdx.x * 4 + (threadIdx.x >> 6);
    const f32x4* yr = (const f32x4*)(Y + (size_t)row * DM) + lane; f32x4* orow = (f32x4*)(out + (size_t)row * DM) + lane;
    f32x4 v[4]; float s = 0.f;
#pragma unroll
    for (int j = 0; j < 4; ++j) { v[j] = yr[64 * j]; s += (v[j][0] * v[j][0] + v[j][1] * v[j][1]) + (v[j][2] * v[j][2] + v[j][3] * v[j][3]); }
    const float rs = rsqrtf(wave_sum(s) * (1.f / DM) + EPS);
#pragma unroll
    for (int j = 0; j < 4; ++j) orow[64 * j] = orow[64 * j] + v[j] * rs * ((const f32x4*)g)[lane + 64 * j];
}

extern "C" void kernel_launch(void* const* d_in, const int* in_sizes, int n_in, void* d_out, int out_size, void* d_ws, size_t ws_size, hipStream_t stream) {
    if (n_in != 17 || in_sizes[0] != M * DM || out_size != M * DM || ws_size < WS_END) { fprintf(stderr, "kernel_launch: unexpected shapes (n_in %d, in0 %d, out %d, ws %zu); nothing launched\n", n_in, n_in > 0 ? in_sizes[0] : -1, out_size, ws_size); return; }
    Ptrs P{};
    P.x = (const float*)d_in[0]; P.pos = (const int*)d_in[1]; P.g_pre = (const float*)d_in[2]; P.w_in = (const float*)d_in[3]; P.g_q = (const float*)d_in[4]; P.w_qb = (const float*)d_in[5];
    P.g_kv = (const float*)d_in[6]; P.w_kvb = (const float*)d_in[7]; P.sinks = (const float*)d_in[8]; P.w_oa = (const float*)d_in[9]; P.w_ob = (const float*)d_in[10]; P.w_out = (const float*)d_in[11];
    P.g_post = (const float*)d_in[12]; P.g_mlp = (const float*)d_in[13]; P.w_up = (const float*)d_in[14]; P.w_dn = (const float*)d_in[15]; P.g_postmlp = (const float*)d_in[16];
    P.out = (float*)d_out; P.ws = (unsigned char*)d_ws;
    unsigned char* ws = (unsigned char*)d_ws;
    bf16 *XN = (bf16*)(ws + WS_XN), *G = (bf16*)(ws + WS_G), *QA = (bf16*)(ws + WS_QA), *KA = (bf16*)(ws + WS_KA), *VA = (bf16*)(ws + WS_VA), *CQ = (bf16*)(ws + WS_CQ), *CKV = (bf16*)(ws + WS_CKV),
         *KR = (bf16*)(ws + WS_KR), *QB = (bf16*)(ws + WS_QB), *KN = (bf16*)(ws + WS_KN), *VB = (bf16*)(ws + WS_VB), *OA = (bf16*)(ws + WS_OA), *OB = (bf16*)(ws + WS_OB), *MRG = (bf16*)(ws + WS_MRG),
         *H = (bf16*)(ws + WS_H);
    float *SQ = (float*)(ws + WS_SSQ_CQ), *SKV = (float*)(ws + WS_SSQ_CKV), *Y1 = (float*)(ws + WS_Y1), *Y2 = (float*)(ws + WS_Y2);
    hipMemsetAsync(ws + WS_CTL, 0, CTL_ZERO_BYTES, stream);
    static bool attr_done = false;
    if (!attr_done) { hipFuncSetAttribute((const void*)k_prologue, hipFuncAttributeMaxDynamicSharedMemorySize, 8 * 64 * 33 * 4); attr_done = true; }
    k_prologue<<<256, 512, 8 * 64 * 33 * 4, stream>>>(P);
    { EpiIn E{G, QA, KA, VA, CQ, CKV, KR, P.pos}; n_gemm<EpiIn, false><<<dim3(NINP / 64, M / 128), 256, 0, stream>>>(XN, (const bf16*)(ws + WS_WIN), nullptr, nullptr, DM, E); }
    n_ssq<<<M / 256, 256, 0, stream>>>(CQ, CKV, SQ, SKV);
    { EpiQB E{QB, SQ, P.pos}; n_gemm<EpiQB, false><<<dim3(NQB / 64, M / 128), 256, 0, stream>>>(CQ, (const bf16*)(ws + WS_WQB), nullptr, nullptr, 256, E); }
    { EpiKVB E{KN, VB, SKV}; n_gemm<EpiKVB, false><<<dim3(NKVB / 64, M / 128), 256, 0, stream>>>(CKV, (const bf16*)(ws + WS_WKVB), nullptr, nullptr, 128, E); }
    n_attn_mla<<<BATCH * 8 * SEQ / 256, 256, 0, stream>>>(QB, KN, KR, VB, OB);
    n_attn_swa<<<BATCH * 8 * SEQ / 256, 256, 0, stream>>>(QA, KA, VA, P.pos, P.sinks, OA);
    { EpiGate E{G, MRG}; n_gemm<EpiGate, true><<<dim3(DM / 64, M / 128), 256, 0, stream>>>(OA, (const bf16*)(ws + WS_WOA), OB, (const bf16*)(ws + WS_WOB), 512, E); }
    { EpiY E{Y1}; n_gemm<EpiY, false><<<dim3(DM / 64, M / 128), 256, 0, stream>>>(MRG, (const bf16*)(ws + WS_WOUT), nullptr, nullptr, DM, E); }
    n_norm1<<<M / 4, 256, 0, stream>>>(Y1, P.x, P.g_post, P.g_mlp, P.out, XN);
    { EpiRelu2 E{H}; n_gemm<EpiRelu2, false><<<dim3(FF / 64, M / 128), 256, 0, stream>>>(XN, (const bf16*)(ws + WS_WUP), nullptr, nullptr, DM, E); }
    { EpiY E{Y2}; n_gemm<EpiY, false><<<dim3(DM / 64, M / 128), 256, 0, stream>>>(H, (const bf16*)(ws + WS_WDN), nullptr, nullptr, FF, E); }
    n_norm2<<<M / 4, 256, 0, stream>>>(Y2, P.g_postmlp, P.out);
}
```
